# Optimizing an MI355X kernel written in HIP

```python
import math
import jax, jax.numpy as jnp
from jax import lax
import numpy as np

D_MODEL = 1024
BATCH = 4
SEQ = 8192
DEPTH = 2

HEAD_DIM = 64
SB_HEADS = D_MODEL // (4 * HEAD_DIM)
SWA_HEADS = D_MODEL // (2 * HEAD_DIM)
SWA_KV_HEADS = SWA_HEADS // 4
ML_HEADS = D_MODEL // (4 * HEAD_DIM)
SB_WIDTH = SB_HEADS * HEAD_DIM
SWA_WIDTH = SWA_HEADS * HEAD_DIM
SWA_KV_WIDTH = SWA_KV_HEADS * HEAD_DIM
ML_WIDTH = ML_HEADS * HEAD_DIM
MIX_WIDTH = SB_WIDTH + SWA_WIDTH + ML_WIDTH
IN_SPLITS = (SB_WIDTH, SB_WIDTH, SB_WIDTH, SWA_WIDTH, SWA_KV_WIDTH, SWA_KV_WIDTH,
             2 * ML_WIDTH, ML_WIDTH, ML_HEADS, ML_HEADS, ML_WIDTH)
N_IN = sum(IN_SPLITS)
BLOCK = 128
WINDOW = 128
ML_CHUNK = 128
CONV_WIDTH = 4
NUM_BUCKETS = 32
MAX_DISTANCE = 128
MEM_TOKENS = 256
XATTN_HEADS = 4
XATTN_HEAD_DIM = D_MODEL // XATTN_HEADS
D_FF = ((8 * D_MODEL // 3 + 255) // 256) * 256
ALPHA = (2 * DEPTH) ** 0.25
BETA = (8 * DEPTH) ** -0.25
LN_EPS = 1e-5

kernel_name = "hybrid_sb_swa_mlstm_macaron_deepnorm"


def layer_norm(x, g, b):
    xf = x.astype(jnp.float32)
    mu = xf.mean(-1, keepdims=True)
    var = jnp.square(xf - mu).mean(-1, keepdims=True)
    return ((xf - mu) * lax.rsqrt(var + LN_EPS) * g + b).astype(x.dtype)


def swiglu(x, w_in, w_out):
    a, b = jnp.split(x @ w_in, 2, axis=-1)
    return (jax.nn.silu(a) * b) @ w_out


def t5_bucket(dist):
    max_exact = NUM_BUCKETS // 2
    d = np.maximum(dist, 1)
    large = max_exact + (np.log(d / max_exact) / np.log(MAX_DISTANCE / max_exact)
                         * (NUM_BUCKETS - max_exact)).astype(np.int32)
    large = np.minimum(large, NUM_BUCKETS - 1)
    return np.where(dist < max_exact, dist, large).astype(np.int32)


def causal_conv(x, w, b):
    out = lax.conv_general_dilated(x, w[:, None, :], window_strides=(1,),
                                   padding=[(CONV_WIDTH - 1, 0)],
                                   dimension_numbers=('NWC', 'WIO', 'NWC'),
                                   feature_group_count=x.shape[-1])
    return out + b


def stick_breaking(q, k, v):
    bsz, s_len, h, d = q.shape
    nb = s_len // BLOCK
    kf = k.astype(jnp.float32).transpose(0, 2, 1, 3)
    vf = v.astype(jnp.float32).transpose(0, 2, 1, 3)
    qb = (q.astype(jnp.float32) * d ** -0.5).reshape(bsz, nb, BLOCK, h, d).transpose(1, 0, 3, 2, 4)
    key_pos = jnp.arange(s_len)

    def block(args):
        q_blk, blk = args
        t = blk * BLOCK + jnp.arange(BLOCK)
        causal = key_pos[None, :] < t[:, None]
        z = jnp.einsum('bhqd,bhsd->bhqs', q_blk, kf)
        log_one_minus = jnp.where(causal, jax.nn.log_sigmoid(-z), 0.0)
        after = lax.cumsum(log_one_minus, axis=3, reverse=True) - log_one_minus
        weight = jnp.where(causal, jnp.exp(jax.nn.log_sigmoid(z) + after), 0.0)
        return jnp.einsum('bhqs,bhsd->bhqd', weight, vf)

    out = lax.map(block, (qb, jnp.arange(nb)))
    return out.transpose(1, 0, 3, 2, 4).reshape(bsz, s_len, h * d).astype(q.dtype)


def sliding_window_attention(q, k, v, sinks, rel_bias):
    bsz, s_len, h, d = q.shape
    hkv = k.shape[2]
    g = h // hkv
    nb = s_len // BLOCK
    qf = (q.astype(jnp.float32) * d ** -0.5).reshape(bsz, nb, BLOCK, hkv, g, d)

    def band(t):
        tb = t.astype(jnp.float32).reshape(bsz, nb, BLOCK, hkv, d)
        prev = jnp.concatenate([jnp.zeros_like(tb[:, :1]), tb[:, :-1]], axis=1)
        return jnp.concatenate([prev, tb], axis=2)

    kb, vb = band(k), band(v)
    qi = np.arange(BLOCK)[:, None]
    kj = np.arange(2 * BLOCK)[None, :]
    dist = qi + BLOCK - kj
    in_window = (dist >= 0) & (dist < WINDOW)
    bucket = t5_bucket(np.clip(dist, 0, None))
    bias = rel_bias.astype(jnp.float32)[bucket]
    bias = bias.transpose(2, 0, 1).reshape(hkv, g, BLOCK, 2 * BLOCK)
    key_valid = (np.arange(nb)[:, None] * BLOCK + kj - BLOCK) >= 0
    mask = in_window[None] & key_valid[:, None, :]
    logits = jnp.einsum('bnqkgd,bnskd->bnkgqs', qf, kb) + bias
    logits = jnp.where(mask[None, :, None, None], logits, -jnp.inf)
    sink = sinks.astype(jnp.float32).reshape(hkv, g)[:, :, None, None]
    m = jnp.maximum(logits.max(-1, keepdims=True), sink)
    p = jnp.exp(logits - m)
    denom = p.sum(-1, keepdims=True) + jnp.exp(sink - m)
    out = jnp.einsum('bnkgqs,bnskd->bnqkgd', p / denom, vb)
    return out.reshape(bsz, s_len, h * d).astype(q.dtype)


def mlstm(q, k, v, i_raw, f_raw, norm_g):
    bsz, s_len, h, d = q.shape
    L = ML_CHUNK
    nc = s_len // L

    def chunks(t):
        return t.astype(jnp.float32).reshape(bsz, nc, L, h, d).transpose(1, 0, 3, 2, 4)

    def chunks_gate(t):
        return t.astype(jnp.float32).reshape(bsz, nc, L, h).transpose(1, 0, 3, 2)

    qc, kc, vc = chunks(q), chunks(k) * d ** -0.5, chunks(v)
    ic = chunks_gate(i_raw)
    b = jnp.cumsum(jax.nn.log_sigmoid(chunks_gate(f_raw)), axis=-1)

    def step(carry, inp):
        C, n, m = carry
        k_c, v_c, i_c, b_c = inp
        b_end = b_c[..., -1]
        w_log = b_end[..., None] - b_c + i_c
        m_new = jnp.maximum(b_end + m, w_log.max(-1))
        decay = jnp.exp(b_end + m - m_new)
        w = jnp.exp(w_log - m_new[..., None])
        C_new = decay[..., None, None] * C + jnp.einsum('bhl,bhlk,bhlv->bhkv', w, k_c, v_c)
        n_new = decay[..., None] * n + jnp.einsum('bhl,bhlk->bhk', w, k_c)
        return (C_new, n_new, m_new), (C, n, m)

    init = (jnp.zeros((bsz, h, d, d), jnp.float32), jnp.zeros((bsz, h, d), jnp.float32),
            jnp.zeros((bsz, h), jnp.float32))
    _, (C_prev, n_prev, m_prev) = lax.scan(step, init, (kc, vc, ic, b))

    g = b + m_prev[..., None]
    causal = np.tril(np.ones((L, L), dtype=bool))
    D = jnp.where(causal, b[..., :, None] - b[..., None, :] + ic[..., None, :], -jnp.inf)
    m_t = jnp.maximum(g, D.max(-1))
    s = jnp.einsum('cbhld,cbhsd->cbhls', qc, kc) * jnp.exp(D - m_t[..., None])
    inter = jnp.exp(g - m_t)
    num = inter[..., None] * jnp.einsum('cbhld,cbhdv->cbhlv', qc, C_prev) \
        + jnp.einsum('cbhls,cbhsv->cbhlv', s, vc)
    den = inter * jnp.einsum('cbhld,cbhd->cbhl', qc, n_prev) + s.sum(-1)
    hid = num / jnp.maximum(jnp.abs(den), jnp.exp(-m_t))[..., None]
    mu = hid.mean(-1, keepdims=True)
    var = jnp.square(hid - mu).mean(-1, keepdims=True)
    hid = (hid - mu) * lax.rsqrt(var + LN_EPS)
    hid = hid.transpose(1, 0, 3, 2, 4).reshape(bsz, s_len, h * d).astype(q.dtype)
    return hid * norm_g


def hybrid_mixer(x, w_in, conv_w, conv_b, i_bias, f_bias, ml_norm_g, sinks, rel_bias, w_out):
    bsz, s_len, _ = x.shape
    idx = [int(i) for i in np.cumsum(IN_SPLITS)[:-1]]
    (q_sb, k_sb, v_sb, q_sw, k_sw, v_sw, qk_ml, v_ml, i_ml, f_ml, o_ml) = jnp.split(x @ w_in, idx, axis=-1)

    def heads(t):
        return t.reshape(bsz, s_len, -1, HEAD_DIM)

    y_sb = stick_breaking(heads(q_sb), heads(k_sb), heads(v_sb))
    y_sw = sliding_window_attention(heads(q_sw), heads(k_sw), heads(v_sw), sinks, rel_bias)
    q_ml, k_ml = jnp.split(jax.nn.silu(causal_conv(qk_ml, conv_w, conv_b)), 2, axis=-1)
    y_ml = jax.nn.sigmoid(o_ml) * mlstm(heads(q_ml), heads(k_ml), heads(v_ml),
                                        i_ml + i_bias, f_ml + f_bias, ml_norm_g)
    y = jnp.concatenate([y_sb, y_sw, y_ml.astype(y_sb.dtype)], axis=-1)
    return y @ w_out


def cross_attention(x, mem, w_q, w_kv, w_o):
    bsz, s_len, _ = x.shape
    q = (x @ w_q).reshape(bsz, s_len, XATTN_HEADS, XATTN_HEAD_DIM).astype(jnp.float32)
    k, v = jnp.split(mem @ w_kv, 2, axis=-1)
    k = k.reshape(bsz, -1, XATTN_HEADS, XATTN_HEAD_DIM).astype(jnp.float32)
    v = v.reshape(bsz, -1, XATTN_HEADS, XATTN_HEAD_DIM).astype(jnp.float32)
    p = jax.nn.softmax(jnp.einsum('bshd,bmhd->bhsm', q, k) * XATTN_HEAD_DIM ** -0.5, axis=-1)
    out = jnp.einsum('bhsm,bmhd->bshd', p, v).reshape(bsz, s_len, D_MODEL).astype(x.dtype)
    return out @ w_o


def setup_inputs(seed: int = 0) -> dict:
    key = jax.random.key(seed)
    ks = jax.random.split(key, 22)
    f32 = jnp.float32

    def dense(k, shape, fan_in, scale=1.0):
        return jax.random.normal(k, shape, f32) * (scale * fan_in ** -0.5)

    return {
        "x": jax.random.normal(ks[0], (BATCH, SEQ, D_MODEL), f32),
        "mem": jax.random.normal(ks[1], (BATCH, MEM_TOKENS, D_MODEL), f32),
        "ffn1_w_in": dense(ks[2], (DEPTH, D_MODEL, 2 * D_FF), D_MODEL),
        "ffn1_w_out": dense(ks[3], (DEPTH, D_FF, D_MODEL), D_FF, BETA),
        "mix_w_in": dense(ks[4], (DEPTH, D_MODEL, N_IN), D_MODEL),
        "ml_conv_w": dense(ks[5], (DEPTH, CONV_WIDTH, 2 * ML_WIDTH), CONV_WIDTH),
        "ml_conv_b": 0.01 * jax.random.normal(ks[6], (DEPTH, 2 * ML_WIDTH), f32),
        "ml_i_bias": 0.1 * jax.random.normal(ks[7], (DEPTH, ML_HEADS), f32),
        "ml_f_bias": jnp.linspace(3.0, 6.0, ML_HEADS, dtype=f32)[None, :]
                     + 0.1 * jax.random.normal(ks[8], (DEPTH, ML_HEADS), f32),
        "ml_norm_g": 1.0 + 0.01 * jax.random.normal(ks[9], (DEPTH, ML_WIDTH), f32),
        "swa_sinks": 0.5 * jax.random.normal(ks[10], (DEPTH, SWA_HEADS), f32),
        "rel_bias": 0.1 * jax.random.normal(ks[11], (NUM_BUCKETS, SWA_HEADS), f32),
        "mix_w_out": dense(ks[12], (DEPTH, MIX_WIDTH, D_MODEL), MIX_WIDTH, BETA),
        "xattn_w_q": dense(ks[13], (DEPTH, D_MODEL, D_MODEL), D_MODEL),
        "xattn_w_kv": dense(ks[14], (DEPTH, D_MODEL, 2 * D_MODEL), D_MODEL),
        "xattn_w_o": dense(ks[15], (DEPTH, D_MODEL, D_MODEL), D_MODEL, BETA),
        "ffn2_w_in": dense(ks[16], (DEPTH, D_MODEL, 2 * D_FF), D_MODEL),
        "ffn2_w_out": dense(ks[17], (DEPTH, D_FF, D_MODEL), D_FF, BETA),
        "ln_g": 1.0 + 0.01 * jax.random.normal(ks[18], (DEPTH, 4, D_MODEL), f32),
        "ln_b": 0.01 * jax.random.normal(ks[19], (DEPTH, 4, D_MODEL), f32),
    }


def reference(x, mem, ffn1_w_in, ffn1_w_out, mix_w_in, ml_conv_w, ml_conv_b, ml_i_bias, ml_f_bias,
              ml_norm_g, swa_sinks, rel_bias, mix_w_out, xattn_w_q, xattn_w_kv, xattn_w_o,
              ffn2_w_in, ffn2_w_out, ln_g, ln_b):
    for l in range(DEPTH):
        x = layer_norm(ALPHA * x + 0.5 * swiglu(x, ffn1_w_in[l], ffn1_w_out[l]), ln_g[l, 0], ln_b[l, 0])
        x = layer_norm(ALPHA * x + hybrid_mixer(x, mix_w_in[l], ml_conv_w[l], ml_conv_b[l], ml_i_bias[l],
                                                ml_f_bias[l], ml_norm_g[l], swa_sinks[l], rel_bias,
                                                mix_w_out[l]),
                       ln_g[l, 1], ln_b[l, 1])
        x = layer_norm(ALPHA * x + cross_attention(x, mem, xattn_w_q[l], xattn_w_kv[l], xattn_w_o[l]),
                       ln_g[l, 2], ln_b[l, 2])
        x = layer_norm(ALPHA * x + 0.5 * swiglu(x, ffn2_w_in[l], ffn2_w_out[l]), ln_g[l, 3], ln_b[l, 3])
    return x
```

```cpp
#include <hip/hip_runtime.h>
#include <hip/hip_cooperative_groups.h>
#include <cstdint>
#include <cstdio>
namespace cg = cooperative_groups;

#define LAS __attribute__((address_space(3)))
typedef unsigned short bf16_t;
typedef short bf16x8 __attribute__((ext_vector_type(8)));
typedef short s16x4 __attribute__((ext_vector_type(4)));
typedef float f32x4 __attribute__((ext_vector_type(4)));
typedef float f32x2 __attribute__((ext_vector_type(2)));
typedef float f32x16 __attribute__((ext_vector_type(16)));
typedef unsigned u32x4 __attribute__((ext_vector_type(4)));
typedef unsigned u32x2 __attribute__((ext_vector_type(2)));

constexpr int DM = 1024, BATCH = 4, SEQ = 8192, T = BATCH * SEQ, DEPTH = 2, DFF = 2816;
constexpr int NIN = 2568, NINP = 2816, PLD = 2560;
constexpr int MEMT = 256;
constexpr float ALPHA = 1.4142135623730951f;
constexpr float LN_EPS = 1e-5f;
constexpr float LOG2E = 1.4426950408889634f;
constexpr int NTHR = 512, NWAVES = 8;

constexpr size_t MiB = 1u << 20;
constexpr size_t WS_BIAST = 0;
constexpr size_t WS_CTR = 65536;
constexpr size_t WS_WFI = 1 * MiB;
constexpr size_t WS_WFO = 45 * MiB;
constexpr size_t WS_WMI = 67 * MiB;
constexpr size_t WS_WMO = 78 * MiB;
constexpr size_t WS_WQK = 82 * MiB;
constexpr size_t WS_VWO = 98 * MiB;
constexpr size_t WS_XB = 114 * MiB;
constexpr size_t WS_PRE = 178 * MiB;
constexpr size_t WS_VTSB = WS_PRE;
constexpr size_t WS_VTSW = WS_PRE + 16 * MiB;
constexpr size_t WS_VTML = WS_PRE + 24 * MiB;
constexpr size_t WS_GATES = WS_PRE + 40 * MiB;
constexpr size_t WS_ULOC = WS_PRE + 41 * MiB;
constexpr size_t WS_NKLOC = WS_PRE + 57 * MiB;
constexpr size_t WS_SCAL = WS_PRE + 58 * MiB;
constexpr size_t WS_R1 = 306 * MiB;
constexpr size_t WS_WQB = WS_R1;
constexpr size_t WS_WKVT = WS_R1 + 4 * MiB;
constexpr size_t WS_WOT = WS_R1 + 12 * MiB;
constexpr size_t WS_MEMB = WS_R1 + 16 * MiB;
constexpr size_t WS_KV = WS_R1 + 18 * MiB;
constexpr size_t WS_END = 482 * MiB;

constexpr int LDS_BYTES = 147456;
constexpr int LDS_EPI = 131072;

__device__ __forceinline__ unsigned f2bf(float f) { unsigned u = __float_as_uint(f); return (u + 0x7fffu + ((u >> 16) & 1u)) >> 16; }
__device__ __forceinline__ unsigned pk2(float lo, float hi) { return f2bf(lo) | (f2bf(hi) << 16); }
__device__ __forceinline__ unsigned cvt_pk(float lo, float hi) { unsigned r; asm("v_cvt_pk_bf16_f32 %0, %1, %2" : "=v"(r) : "v"(lo), "v"(hi)); return r; }
__device__ __forceinline__ float bf2f(bf16_t b) { return __uint_as_float(((unsigned)b) << 16); }
__device__ __forceinline__ float ex2(float x) { return __builtin_amdgcn_exp2f(x); }
__device__ __forceinline__ float rcpf_(float x) { return __builtin_amdgcn_rcpf(x); }
__device__ __forceinline__ int crow(int r, int hi) { return (r & 3) + 8 * (r >> 2) + 4 * hi; }
__device__ __forceinline__ float wave_sum(float v) {
#pragma unroll
    for (int o = 1; o < 64; o <<= 1) v += __shfl_xor(v, o);
    return v;
}
#define LDS_WAIT() asm volatile("s_waitcnt lgkmcnt(0)" ::: "memory")
__device__ __forceinline__ int sopq(int x) { asm volatile("" : "+s"(x)); return x; }
__device__ __forceinline__ int lane_fresh() { int l; asm volatile("v_mbcnt_lo_u32_b32 %0, -1, 0\n\tv_mbcnt_hi_u32_b32 %0, -1, %0" : "=v"(l)); return l; }

namespace pg8 {
constexpr int BM = 256, BK = 64, HALF = 128, HTB = HALF * BK * 2, NXCD = 8, WGM = 8;
__device__ __forceinline__ int lds_byte(int r, int c) { const int st = (r >> 4) * 2 + (c >> 5), rr = r & 15, cc = c & 31, ob = rr * 64 + cc * 2; return st * 1024 + (ob ^ (((ob >> 9) & 1) << 5)); }
__device__ __forceinline__ void stage_rc(int b, int& R, int& C) { const int st = b / 1024, sb = b % 1024, swz = sb ^ (((sb >> 9) & 1) << 5); R = (st >> 1) * 16 + swz / 64; C = (st & 1) * 32 + (swz % 64) / 2; }
__device__ __forceinline__ int perm32(int rho) { const int n = rho >> 4, i = rho & 15; return 8 * (i >> 2) + 4 * n + (i & 3); }

struct Unit { int pm, pn, g; };
struct Gemm { const bf16_t* A; const bf16_t* Bt; int lda, ldb, K; };

struct BigOrder {
    int nM, nN, nwg, G, c, lda, ldb; long bgs;
    __device__ void init(int M, int N, int G_, int c_, int lda_, int ldb_, long bgs_) { nM = M / BM; nN = N / BM; nwg = nM * nN; G = G_; c = c_; lda = lda_; ldb = ldb_; bgs = bgs_; }
    __device__ bool next(int i, Unit& u) const {
        const long L = (long)i * G + c; if (L >= nwg) return false;
        int wgid = (int)L; { const int q = nwg / NXCD, r = nwg % NXCD, xcd = wgid % NXCD, off = wgid / NXCD; wgid = (xcd < r ? xcd * (q + 1) : r * (q + 1) + (xcd - r) * q) + off; }
        const int nig = WGM * nN, gid = wgid / nig, fm = gid * WGM, gsz = (nM - fm) < WGM ? (nM - fm) : WGM;
        u.pm = fm + ((wgid % nig) % gsz); u.pn = (wgid % nig) / gsz; u.g = u.pm >> 5; return true;
    }
    __device__ __forceinline__ long a_off(const Unit& u) const { return (long)u.pm * BM * lda; }
    __device__ __forceinline__ long b_off(const Unit& u) const { return (long)u.g * bgs + (long)u.pn * BM * ldb; }
};

struct EpiBf16G {
    static constexpr bool PERM = true;
    bf16_t* O; int ldc; float sc; int kind;
    __device__ __forceinline__ long c_off(const Unit& u) const {
        if (kind == 0) return (long)u.g * 1024 * 2048 + (long)u.pm * 256 * 2048 + u.pn * 256;
        const int l = u.g >> 4, b = (u.g >> 2) & 3, h = u.g & 3;
        if (kind == 1) return (long)(l * 4 + b) * 1024 * 1024 + (long)(h * 256) * 1024 + u.pn * 256;
        return (long)(l * 4 + b) * 1024 * 1024 + (long)(u.pm * 256) * 1024 + h * 256;
    }
    __device__ __forceinline__ void operator()(f32x4 (&acc)[2][2][4][2], const Unit& u, int wr, int wc, int fr, int fq, LAS unsigned char*) const {
        bf16_t* base = O + c_off(u) + (size_t)(wr * 64 + fr) * ldc + wc * 32 + 8 * fq;
#pragma unroll
        for (int ai = 0; ai < 2; ++ai)
#pragma unroll
            for (int m = 0; m < 4; ++m) { bf16_t* rowp = base + (size_t)(ai * HALF + m * 16) * ldc;
#pragma unroll
                for (int bj = 0; bj < 2; ++bj) { const f32x4 v0 = acc[ai][bj][m][0] * sc, v1 = acc[ai][bj][m][1] * sc;
                    u32x4 w; w.x = cvt_pk(v0[0], v0[1]); w.y = cvt_pk(v0[2], v0[3]); w.z = cvt_pk(v1[0], v1[1]); w.w = cvt_pk(v1[2], v1[3]);
                    *(u32x4*)(rowp + bj * HALF) = w; } }
    }
};
struct EpiSwiGLU {
    static constexpr bool PERM = true;
    bf16_t* H;
    __device__ __forceinline__ void operator()(f32x4 (&acc)[2][2][4][2], const Unit& u, int wr, int wc, int fr, int fq, LAS unsigned char*) const {
        bf16_t* base = H + (size_t)(u.pm * BM + wr * 64 + fr) * DFF + u.pn * 128 + wc * 32 + 8 * fq;
#pragma unroll
        for (int ai = 0; ai < 2; ++ai)
#pragma unroll
            for (int m = 0; m < 4; ++m) {
                float h[8];
#pragma unroll
                for (int n = 0; n < 2; ++n)
#pragma unroll
                    for (int j = 0; j < 4; ++j) { const float a = acc[ai][0][m][n][j], b = acc[ai][1][m][n][j];
                        const float e = ex2(-a * LOG2E); h[4 * n + j] = a * b * rcpf_(1.f + e); }
                u32x4 w; w.x = cvt_pk(h[0], h[1]); w.y = cvt_pk(h[2], h[3]); w.z = cvt_pk(h[4], h[5]); w.w = cvt_pk(h[6], h[7]);
                *(u32x4*)(base + (size_t)(ai * HALF + m * 16) * DFF) = w; }
    }
};
struct EpiResid {
    static constexpr bool PERM = false;
    const float* X; float* OUT; float s;
    __device__ __forceinline__ void operator()(f32x4 (&acc)[2][2][4][2], const Unit& u, int wr, int wc, int fr, int fq, LAS unsigned char*) const {
        const int col0 = u.pn * BM + wc * 32 + 4 * fq;
#pragma unroll
        for (int ai = 0; ai < 2; ++ai)
#pragma unroll
            for (int m = 0; m < 4; ++m) { const size_t off = (size_t)(u.pm * BM + ai * HALF + wr * 64 + m * 16 + fr) * DM + col0;
#pragma unroll
                for (int bj = 0; bj < 2; ++bj)
#pragma unroll
                    for (int n = 0; n < 2; ++n) { const f32x4 x = *(const f32x4*)(X + off + bj * HALF + n * 16);
                        *(f32x4*)(OUT + off + bj * HALF + n * 16) = x * ALPHA + acc[ai][bj][m][n] * s; }
                if (m & 1) asm volatile("" ::: "memory"); }
    }
};
struct EpiSoftmax {
    static constexpr bool PERM = true;
    bf16_t* P;
    __device__ __forceinline__ void operator()(f32x4 (&acc)[2][2][4][2], const Unit& u, int wr, int wc, int fr, int fq, LAS unsigned char* lds) const {
        LAS f32x2* X = (LAS f32x2*)(lds + LDS_EPI);
#pragma unroll
        for (int ai = 0; ai < 2; ++ai)
#pragma unroll
            for (int m = 0; m < 4; ++m) {
                float mx = -INFINITY;
#pragma unroll
                for (int bj = 0; bj < 2; ++bj)
#pragma unroll
                    for (int n = 0; n < 2; ++n)
#pragma unroll
                        for (int j = 0; j < 4; ++j) mx = fmaxf(mx, acc[ai][bj][m][n][j]);
                mx = fmaxf(mx, __shfl_xor(mx, 16)); mx = fmaxf(mx, __shfl_xor(mx, 32));
                float s = 0.f;
#pragma unroll
                for (int bj = 0; bj < 2; ++bj)
#pragma unroll
                    for (int n = 0; n < 2; ++n)
#pragma unroll
                        for (int j = 0; j < 4; ++j) { const float e = ex2(acc[ai][bj][m][n][j] - mx); acc[ai][bj][m][n][j] = e; s += e; }
                s += __shfl_xor(s, 16); s += __shfl_xor(s, 32);
                if (fq == 0) X[(ai * HALF + wr * 64 + m * 16 + fr) * 4 + wc] = (f32x2){mx, s};
            }
        LDS_WAIT(); __builtin_amdgcn_s_barrier(); asm volatile("" ::: "memory");
        bf16_t* base = P + (size_t)(u.pm * BM + wr * 64 + fr) * DM + u.pn * BM + wc * 32 + 8 * fq;
#pragma unroll
        for (int ai = 0; ai < 2; ++ai)
#pragma unroll
            for (int m = 0; m < 4; ++m) {
                const int r = ai * HALF + wr * 64 + m * 16 + fr;
                const f32x2 a = X[r * 4 + 0], b = X[r * 4 + 1], c = X[r * 4 + 2], d = X[r * 4 + 3];
                const float M = fmaxf(fmaxf(a.x, b.x), fmaxf(c.x, d.x));
                const float S = a.y * ex2(a.x - M) + b.y * ex2(b.x - M) + c.y * ex2(c.x - M) + d.y * ex2(d.x - M);
                const float own = (wc == 0) ? a.x : (wc == 1) ? b.x : (wc == 2) ? c.x : d.x;
                const float f = ex2(own - M) / S;
                bf16_t* rowp = base + (size_t)(ai * HALF + m * 16) * DM;
#pragma unroll
                for (int bj = 0; bj < 2; ++bj) { const f32x4 v0 = acc[ai][bj][m][0] * f, v1 = acc[ai][bj][m][1] * f;
                    u32x4 w; w.x = cvt_pk(v0[0], v0[1]); w.y = cvt_pk(v0[2], v0[3]); w.z = cvt_pk(v1[0], v1[1]); w.w = cvt_pk(v1[2], v1[3]);
                    *(u32x4*)(rowp + bj * HALF) = w; }
            }
        LDS_WAIT(); __builtin_amdgcn_s_barrier(); asm volatile("" ::: "memory");
    }
};
struct EpiMixIn {
    static constexpr bool PERM = true;
    bf16_t* PROJ; bf16_t* VTSB; bf16_t* VTSW; bf16_t* VTML; float* GATES;
    __device__ __forceinline__ void tstore(const f32x4 (&acc)[2][2][4][2], bf16_t* vt, int chan_rows, int bjlo, const Unit& u, int wr, int wc, int fr, int fq) const {
        const int row0 = u.pm * BM + wr * 64 + fr; const int b = row0 / SEQ, tl = row0 % SEQ;
        bf16_t* base = vt + (size_t)b * chan_rows * SEQ + tl;
#pragma unroll
        for (int bj = bjlo; bj < 2; ++bj)
#pragma unroll
            for (int n = 0; n < 2; ++n)
#pragma unroll
                for (int j = 0; j < 4; ++j) { const int c = (bj - bjlo) * HALF + wc * 32 + 8 * fq + 4 * n + j; bf16_t* cp = base + (size_t)c * SEQ;
#pragma unroll
                    for (int ai = 0; ai < 2; ++ai)
#pragma unroll
                        for (int m = 0; m < 4; ++m) cp[ai * HALF + m * 16] = (bf16_t)f2bf(acc[ai][bj][m][n][j]); }
    }
    __device__ __forceinline__ void operator()(f32x4 (&acc)[2][2][4][2], const Unit& u, int wr, int wc, int fr, int fq, LAS unsigned char*) const {
        const int pn = u.pn;
        if (pn == 2) { tstore(acc, VTSB, 256, 0, u, wr, wc, fr, fq); return; }
        if (pn == 8) { tstore(acc, VTML, 256, 0, u, wr, wc, fr, fq); return; }
        if (pn == 10) {
            if (wc == 0 && fq == 0) {
#pragma unroll
                for (int ai = 0; ai < 2; ++ai)
#pragma unroll
                    for (int m = 0; m < 4; ++m) { float* gp = GATES + (size_t)(u.pm * BM + ai * HALF + wr * 64 + m * 16 + fr) * 8;
                        *(f32x4*)gp = acc[ai][0][m][0]; *(f32x4*)(gp + 4) = acc[ai][0][m][1]; }
            }
            return;
        }
        if (pn == 5) tstore(acc, VTSW, 128, 1, u, wr, wc, fr, fq);
        const int nbj = (pn == 5) ? 1 : 2;
        bf16_t* base = PROJ + (size_t)(u.pm * BM + wr * 64 + fr) * PLD + pn * BM + wc * 32 + 8 * fq;
#pragma unroll
        for (int ai = 0; ai < 2; ++ai)
#pragma unroll
            for (int m = 0; m < 4; ++m) { bf16_t* rowp = base + (size_t)(ai * HALF + m * 16) * PLD;
#pragma unroll
                for (int bj = 0; bj < 2; ++bj) if (bj < nbj) { const f32x4 v0 = acc[ai][bj][m][0], v1 = acc[ai][bj][m][1];
                    u32x4 w; w.x = cvt_pk(v0[0], v0[1]); w.y = cvt_pk(v0[2], v0[3]); w.z = cvt_pk(v1[0], v1[1]); w.w = cvt_pk(v1[2], v1[3]);
                    *(u32x4*)(rowp + bj * HALF) = w; } }
    }
};

template <class Epi, class Sched>
__device__ __forceinline__ void gemm_phase(LAS unsigned char* lds, const Gemm g, const Sched& S, const Epi& E, int wid) {
    const int lane = lane_fresh(), tid = wid * 64 + lane, wr = wid >> 2, wc = wid & 3, fr = lane & 15, fq = lane >> 4;
    const int K = g.K, nt = K / BK;
    unsigned voffA[2], voffB[2];
#pragma unroll
    for (int i = 0; i < 2; ++i) { int R, C; stage_rc(tid * 16 + i * 8192, R, C); const int Rb = Epi::PERM ? ((R & ~31) + perm32(R & 31)) : R;
        voffA[i] = (unsigned)(R * g.lda + C) * 2u; voffB[i] = (unsigned)(Rb * g.ldb + C) * 2u; }
    const size_t kstep = (size_t)(BK * 2);
    const size_t hA = (size_t)HALF * g.lda * 2, hB = (size_t)HALF * g.ldb * 2;
    const unsigned ldsw = (unsigned)wid * 1024u;
    const int aoff = lds_byte(wr * 64 + fr, fq * 8), boff = lds_byte(wc * 32 + fr, fq * 8);
#define PG8_SA(b, h) (((b) * 2 + (h)) * HTB)
#define PG8_SB(b, h) ((4 + (b) * 2 + (h)) * HTB)
#define PG8_STAGE(bufoff, gbase, voff) do { _Pragma("unroll") for (int _i = 0; _i < 2; ++_i) \
        __builtin_amdgcn_global_load_lds((const unsigned*)((const char*)(gbase) + (voff)[_i]), (LAS unsigned*)(lds + (bufoff) + ldsw + _i * 8192), 16, 0, 0); } while (0)
#define PG8_LDA(dst, b, h) do { _Pragma("unroll") for (int m = 0; m < 4; ++m) _Pragma("unroll") for (int k = 0; k < 2; ++k) dst[m][k] = *(const LAS bf16x8*)(lds + PG8_SA(b, h) + aoff + m * 2048 + k * 1024); } while (0)
#define PG8_LDB(dst, b, h) do { _Pragma("unroll") for (int n = 0; n < 2; ++n) _Pragma("unroll") for (int k = 0; k < 2; ++k) dst[n][k] = *(const LAS bf16x8*)(lds + PG8_SB(b, h) + boff + n * 2048 + k * 1024); } while (0)
#define PG8_MMA(ai, bj, At, Bt) do { __builtin_amdgcn_s_setprio(1); _Pragma("unroll") for (int m = 0; m < 4; ++m) _Pragma("unroll") for (int n = 0; n < 2; ++n) _Pragma("unroll") for (int k = 0; k < 2; ++k) \
        acc[ai][bj][m][n] = __builtin_amdgcn_mfma_f32_16x16x32_bf16(Bt[n][k], At[m][k], acc[ai][bj][m][n], 0, 0, 0); __builtin_amdgcn_s_setprio(0); } while (0)
#define PG8_WAIT_V(n) asm volatile("s_waitcnt vmcnt(" #n ")" ::: "memory")
#define PG8_WAIT_L(n) asm volatile("s_waitcnt lgkmcnt(" #n ")" ::: "memory")
#define PG8_BAR __builtin_amdgcn_s_barrier()
#define PG8_SCHED __builtin_amdgcn_sched_barrier(0)
    Unit cur, nxt; int ui = 0;
    if (!S.next(0, cur)) return;
    f32x4 acc[2][2][4][2];
#pragma unroll
    for (int a = 0; a < 2; ++a)
#pragma unroll
        for (int b = 0; b < 2; ++b)
#pragma unroll
            for (int m = 0; m < 4; ++m)
#pragma unroll
                for (int n = 0; n < 2; ++n) acc[a][b][m][n] = (f32x4){0.f, 0.f, 0.f, 0.f};
    bf16x8 At[4][2], B0[2][2], B1[2][2];
    const char* cA = (const char*)(g.A + S.a_off(cur)); const char* cB = (const char*)(g.Bt + S.b_off(cur));
    PG8_STAGE(PG8_SB(0, 0), cB, voffB); PG8_STAGE(PG8_SB(0, 1), cB + hB, voffB); PG8_STAGE(PG8_SA(0, 0), cA, voffA); PG8_STAGE(PG8_SA(0, 1), cA + hA, voffA);
    if ((sopq(wid) >> 2) == 1) PG8_BAR;
    PG8_WAIT_V(2); PG8_BAR;
    PG8_STAGE(PG8_SB(1, 0), cB + kstep, voffB); PG8_STAGE(PG8_SA(1, 0), cA + kstep, voffA); PG8_STAGE(PG8_SB(1, 1), cB + hB + kstep, voffB);
    PG8_WAIT_V(6); PG8_BAR;
    for (;;) {
        const bool has_next = S.next(ui + 1, nxt);
        const char* nA = has_next ? (const char*)(g.A + S.a_off(nxt)) : cA; const char* nB = has_next ? (const char*)(g.Bt + S.b_off(nxt)) : cB;
        for (int t = 0; t < nt; t += 2) {
            const bool last = (t == nt - 2);
            const char* a1 = cA + (size_t)(t + 1) * kstep;
            const char* a2 = last ? nA : cA + (size_t)(t + 2) * kstep; const char* b2 = last ? nB : cB + (size_t)(t + 2) * kstep;
            const char* a3 = a2 + kstep; const char* b3 = b2 + kstep;
            PG8_LDB(B0, 0, 0); PG8_LDB(B1, 0, 1); PG8_SCHED; PG8_LDA(At, 0, 0); PG8_STAGE(PG8_SA(1, 1), a1 + hA, voffA);
            PG8_WAIT_V(8); PG8_WAIT_L(0); PG8_BAR; PG8_MMA(0, 0, At, B0); PG8_MMA(0, 1, At, B1); PG8_BAR; PG8_SCHED;
            PG8_LDA(At, 0, 1); PG8_STAGE(PG8_SB(0, 0), b2, voffB); PG8_STAGE(PG8_SB(0, 1), b2 + hB, voffB); PG8_STAGE(PG8_SA(0, 0), a2, voffA);
            PG8_WAIT_V(8); PG8_WAIT_L(0); PG8_BAR; PG8_MMA(1, 0, At, B0); PG8_MMA(1, 1, At, B1); PG8_BAR; PG8_SCHED;
            PG8_LDB(B0, 1, 0); PG8_LDB(B1, 1, 1); PG8_SCHED; PG8_LDA(At, 1, 0); PG8_STAGE(PG8_SA(0, 1), a2 + hA, voffA);
            PG8_WAIT_V(8); PG8_WAIT_L(0); PG8_BAR; PG8_MMA(0, 0, At, B0); PG8_MMA(0, 1, At, B1); PG8_BAR; PG8_SCHED;
            PG8_LDA(At, 1, 1); PG8_STAGE(PG8_SB(1, 0), b3, voffB); PG8_STAGE(PG8_SB(1, 1), b3 + hB, voffB); PG8_STAGE(PG8_SA(1, 0), a3, voffA);
            PG8_WAIT_V(8); PG8_WAIT_L(0); PG8_BAR; PG8_MMA(1, 0, At, B0); PG8_MMA(1, 1, At, B1); PG8_BAR; PG8_SCHED;
        }
        if ((sopq(wid) >> 2) == 0) PG8_BAR;
        { const int ln = lane_fresh(), wq = sopq(wid); E(acc, cur, wq >> 2, wq & 3, ln & 15, ln >> 4, lds); }
        if (!has_next) break;
#pragma unroll
        for (int a = 0; a < 2; ++a)
#pragma unroll
            for (int b = 0; b < 2; ++b)
#pragma unroll
                for (int m = 0; m < 4; ++m)
#pragma unroll
                    for (int n = 0; n < 2; ++n) acc[a][b][m][n] = (f32x4){0.f, 0.f, 0.f, 0.f};
        cur = nxt; cA = nA; cB = nB; ++ui;
        if ((sopq(wid) >> 2) == 1) PG8_BAR;
    }
    PG8_WAIT_V(0);
    PG8_BAR;
#undef PG8_SA
#undef PG8_SB
#undef PG8_STAGE
#undef PG8_LDA
#undef PG8_LDB
#undef PG8_MMA
#undef PG8_WAIT_V
#undef PG8_WAIT_L
#undef PG8_BAR
#undef PG8_SCHED
}
}

__device__ __forceinline__ int srcmap(int mode, int d) {
    if (mode == 0) return d;
    if (mode == 1) { const int t = d >> 8, w = d & 255; return (w < 128) ? t * 128 + w : DFF + t * 128 + (w - 128); }
    if (d < 2304) return d; if (d < 2560) return d + 8; if (d < 2568) return d - 256; return -1;
}
__device__ __forceinline__ void tr_item(const float* W, int K, int N, int ND, bf16_t* WT, int mode, LAS float* scr, int item, int lane) {
#ifdef NO_TR
    return;
#endif

    const int ndb = ND / 32, kb = item / ndb, db = item % ndb, k0 = 64 * kb, d0 = 32 * db;
    const int sc = srcmap(mode, d0 + (lane & 31));
#pragma unroll 8
    for (int i = 0; i < 32; ++i) { const int kk = 2 * i + (lane >> 5); scr[kk * 33 + (lane & 31)] = (sc >= 0) ? W[(size_t)(k0 + kk) * N + sc] : 0.f; }
    LDS_WAIT(); asm volatile("" ::: "memory");
    const int c = lane & 7;
#pragma unroll
    for (int j = 0; j < 4; ++j) { const int n = (lane >> 3) + 8 * j; const LAS float* s = scr + (8 * c) * 33 + n;
        u32x4 o; o.x = pk2(s[0 * 33], s[1 * 33]); o.y = pk2(s[2 * 33], s[3 * 33]); o.z = pk2(s[4 * 33], s[5 * 33]); o.w = pk2(s[6 * 33], s[7 * 33]);
        *(u32x4*)(WT + (size_t)(d0 + n) * K + k0 + 8 * c) = o; }
    LDS_WAIT(); asm volatile("" ::: "memory");
}
__device__ __forceinline__ void cvt_range(const float* src, bf16_t* dst, size_t n8, size_t gt, size_t ngt) {
    for (size_t i = gt; i < n8; i += ngt) { const f32x4 a = *(const f32x4*)(src + i * 8), b = *(const f32x4*)(src + i * 8 + 4);
        u32x4 w; w.x = pk2(a[0], a[1]); w.y = pk2(a[2], a[3]); w.z = pk2(b[0], b[1]); w.w = pk2(b[2], b[3]); *(u32x4*)(dst + i * 8) = w; }
}
__device__ __forceinline__ void ln_rows(const float* pre, const float* g, const float* bt, float* xf, bf16_t* xb, int gw, int ngw, int lane) {
#ifdef NO_LN
    return;
#endif

    f32x4 gg[4], bb[4];
#pragma unroll
    for (int j = 0; j < 4; ++j) { gg[j] = ((const f32x4*)g)[64 * j + lane]; bb[j] = ((const f32x4*)bt)[64 * j + lane]; }
    for (int m = gw; m < T; m += ngw) {
        const f32x4* xr = (const f32x4*)(pre + (size_t)m * DM) + lane;
        f32x4 v[4]; float s = 0.f;
#pragma unroll
        for (int j = 0; j < 4; ++j) { v[j] = xr[64 * j]; s += (v[j].x + v[j].y) + (v[j].z + v[j].w); }
        const float mean = wave_sum(s) * (1.f / DM); float s2 = 0.f;
#pragma unroll
        for (int j = 0; j < 4; ++j) { v[j] = v[j] - mean; s2 += (v[j].x * v[j].x + v[j].y * v[j].y) + (v[j].z * v[j].z + v[j].w * v[j].w); }
        const float rstd = 1.f / sqrtf(wave_sum(s2) * (1.f / DM) + LN_EPS);
        f32x4* of = (f32x4*)(xf + (size_t)m * DM) + lane; u32x2* ob = (u32x2*)(xb + (size_t)m * DM) + lane;
#pragma unroll
        for (int j = 0; j < 4; ++j) { const f32x4 o = v[j] * rstd * gg[j] + bb[j]; of[64 * j] = o; u32x2 w; w.x = pk2(o.x, o.y); w.y = pk2(o.z, o.w); ob[64 * j] = w; }
    }
}

__device__ __forceinline__ void qk_tile(f32x16& p0, f32x16& p1, const bf16_t* kp, int ld, const bf16x8 (&qr)[4]) {
    p0 = (f32x16){}; p1 = (f32x16){};
#pragma unroll
    for (int d0 = 0; d0 < 4; ++d0) {
        const bf16x8 ka = *(const bf16x8*)(kp + 16 * d0), kb = *(const bf16x8*)(kp + (size_t)32 * ld + 16 * d0);
        p0 = __builtin_amdgcn_mfma_f32_32x32x16_bf16(ka, qr[d0], p0, 0, 0, 0);
        p1 = __builtin_amdgcn_mfma_f32_32x32x16_bf16(kb, qr[d0], p1, 0, 0, 0);
    }
}
__device__ __forceinline__ void pv_tile(f32x16& o0, f32x16& o1, const float (&w)[32], const bf16_t* vrow0, const bf16_t* vrow1, int k0, int hi) {
#pragma unroll
    for (int ks = 0; ks < 4; ++ks) {
        u32x4 pw; pw.x = cvt_pk(w[8 * ks + 0], w[8 * ks + 1]); pw.y = cvt_pk(w[8 * ks + 2], w[8 * ks + 3]); pw.z = cvt_pk(w[8 * ks + 4], w[8 * ks + 5]); pw.w = cvt_pk(w[8 * ks + 6], w[8 * ks + 7]);
        const bf16x8 pa = __builtin_bit_cast(bf16x8, pw);
        const int kvb = k0 + 16 * ks + 4 * hi;
        const s16x4 a0 = *(const s16x4*)(vrow0 + kvb), a1 = *(const s16x4*)(vrow0 + kvb + 8);
        const s16x4 b0 = *(const s16x4*)(vrow1 + kvb), b1 = *(const s16x4*)(vrow1 + kvb + 8);
        const bf16x8 va = (bf16x8){a0[0], a0[1], a0[2], a0[3], a1[0], a1[1], a1[2], a1[3]};
        const bf16x8 vb = (bf16x8){b0[0], b0[1], b0[2], b0[3], b1[0], b1[1], b1[2], b1[3]};
        o0 = __builtin_amdgcn_mfma_f32_32x32x16_bf16(va, pa, o0, 0, 0, 0);
        o1 = __builtin_amdgcn_mfma_f32_32x32x16_bf16(vb, pa, o1, 0, 0, 0);
    }
}
__device__ __forceinline__ void o_store(bf16_t* yp, const f32x16& o0, const f32x16& o1, int hi) {
#pragma unroll
    for (int g4 = 0; g4 < 4; ++g4) {
        u32x2 a; a.x = cvt_pk(o0[4 * g4], o0[4 * g4 + 1]); a.y = cvt_pk(o0[4 * g4 + 2], o0[4 * g4 + 3]); *(u32x2*)(yp + 8 * g4 + 4 * hi) = a;
        u32x2 b; b.x = cvt_pk(o1[4 * g4], o1[4 * g4 + 1]); b.y = cvt_pk(o1[4 * g4 + 2], o1[4 * g4 + 3]); *(u32x2*)(yp + 32 + 8 * g4 + 4 * hi) = b;
    }
}

__device__ __forceinline__ void sb_wave(const bf16_t* proj, const bf16_t* vt, bf16_t* y, int b, int h, int qblk, int lane) {
#ifdef NO_SB
    return;
#endif

    const int r32 = lane & 31, hi = lane >> 5; const size_t rowbase = (size_t)b * SEQ; const int t0 = qblk * 32, t = t0 + r32;
    const bf16_t* qp = proj + (rowbase + t) * PLD + h * 64 + hi * 8;
    bf16x8 qr[4];
#pragma unroll
    for (int d0 = 0; d0 < 4; ++d0) qr[d0] = *(const bf16x8*)(qp + 16 * d0);
    f32x16 o0 = (f32x16){}, o1 = (f32x16){};
    float R = 1.f;
    const bf16_t* vrow0 = vt + (size_t)(b * 256 + h * 64 + r32) * SEQ; const bf16_t* vrow1 = vrow0 + (size_t)32 * SEQ;
    const float C2 = 0.125f * LOG2E;
    for (int kt = t0 >> 6; kt >= 0; --kt) {
        const int k0 = kt * 64;
        f32x16 p0, p1;
        qk_tile(p0, p1, proj + (rowbase + k0 + r32) * PLD + 256 + h * 64 + hi * 8, PLD, qr);
        const bool dm = (k0 + 63 >= t0);
        float a[32], w[32];
#pragma unroll
        for (int r = 0; r < 16; ++r) {
            { const float e = ex2(fminf(p0[r] * C2, 80.f)), rr = rcpf_(1.f + e); float be = e * rr, om = rr;
              if (dm && (k0 + crow(r, hi) >= t)) { om = 1.f; be = 0.f; } a[r] = om; w[r] = be; }
            { const float e = ex2(fminf(p1[r] * C2, 80.f)), rr = rcpf_(1.f + e); float be = e * rr, om = rr;
              if (dm && (k0 + 32 + crow(r, hi) >= t)) { om = 1.f; be = 0.f; } a[16 + r] = om; w[16 + r] = be; }
        }
        float x[32], Town[8], Tpar[8];
#pragma unroll
        for (int gi = 0; gi < 8; ++gi) { x[4 * gi + 3] = 1.f; x[4 * gi + 2] = a[4 * gi + 3]; x[4 * gi + 1] = a[4 * gi + 3] * a[4 * gi + 2]; x[4 * gi] = x[4 * gi + 1] * a[4 * gi + 1]; Town[gi] = x[4 * gi] * a[4 * gi]; }
#pragma unroll
        for (int gi = 0; gi < 8; ++gi) Tpar[gi] = __shfl_xor(Town[gi], 32);
        float E = R, Eown[8];
#pragma unroll
        for (int idx = 15; idx >= 0; --idx) { const int gi = (idx >> 3) * 4 + ((idx & 7) >> 1); const int hh = idx & 1;
            const bool mine = (hh == hi); if (mine) Eown[gi] = E; E *= mine ? Town[gi] : Tpar[gi]; }
        R = E;
#pragma unroll
        for (int gi = 0; gi < 8; ++gi)
#pragma unroll
            for (int j = 0; j < 4; ++j) w[4 * gi + j] *= x[4 * gi + j] * Eown[gi];
        pv_tile(o0, o1, w, vrow0, vrow1, k0, hi);
        if (!__any(R >= 1e-30f)) break;
    }
    o_store(y + (rowbase + t) * DM + h * 64, o0, o1, hi);
}

__device__ __forceinline__ void swa_wave(const bf16_t* proj, const bf16_t* vt, const float* biasT, const float* sinks, bf16_t* y, int b, int hq, int qblk, int lane) {
#ifdef NO_SWA
    return;
#endif

    const int r32 = lane & 31, hi = lane >> 5, hk = hq >> 2; const size_t rowbase = (size_t)b * SEQ; const int t0 = qblk * 32, t = t0 + r32;
    const bf16_t* qp = proj + (rowbase + t) * PLD + 768 + hq * 64 + hi * 8;
    bf16x8 qr[4];
#pragma unroll
    for (int d0 = 0; d0 < 4; ++d0) qr[d0] = *(const bf16x8*)(qp + 16 * d0);
    f32x16 o0 = (f32x16){}, o1 = (f32x16){};
    const bf16_t* vrow0 = vt + (size_t)(b * 128 + hk * 64 + r32) * SEQ; const bf16_t* vrow1 = vrow0 + (size_t)32 * SEQ;
    const float* bT = biasT + hq * 128;
    float m = sinks[hq] * LOG2E, l = hi ? 0.f : 1.f;
    const int klo = (t0 - 127) > 0 ? (t0 - 127) : 0;
    for (int kt = klo >> 6; kt <= (t0 >> 6); ++kt) {
        const int k0 = kt * 64;
        f32x16 p0, p1;
        qk_tile(p0, p1, proj + (rowbase + k0 + r32) * PLD + 1280 + hk * 64 + hi * 8, PLD, qr);
        float w[32]; float tm = -INFINITY;
#pragma unroll
        for (int r = 0; r < 16; ++r) {
            { const int dist = t - (k0 + crow(r, hi)); const float bs = bT[dist & 127]; const float lg = ((unsigned)dist < 128u) ? (p0[r] * 0.125f + bs) * LOG2E : -INFINITY; w[r] = lg; tm = fmaxf(tm, lg); }
            { const int dist = t - (k0 + 32 + crow(r, hi)); const float bs = bT[dist & 127]; const float lg = ((unsigned)dist < 128u) ? (p1[r] * 0.125f + bs) * LOG2E : -INFINITY; w[16 + r] = lg; tm = fmaxf(tm, lg); }
        }
        tm = fmaxf(tm, __shfl_xor(tm, 32));
        const float mn = fmaxf(m, tm), al = ex2(m - mn); m = mn;
        float s = 0.f;
#pragma unroll
        for (int r = 0; r < 32; ++r) { w[r] = ex2(w[r] - mn); s += w[r]; }
        l = l * al + s;
#pragma unroll
        for (int r = 0; r < 16; ++r) { o0[r] *= al; o1[r] *= al; }
        pv_tile(o0, o1, w, vrow0, vrow1, k0, hi);
    }
    l += __shfl_xor(l, 32);
    const float inv = 1.f / l;
#pragma unroll
    for (int r = 0; r < 16; ++r) { o0[r] *= inv; o1[r] *= inv; }
    o_store(y + (rowbase + t) * DM + 256 + hq * 64, o0, o1, hi);
}

constexpr int ML_Q = 0, ML_K = 128 * 68, ML_V = 2 * 128 * 68, ML_C = 3 * 128 * 68, ML_IG = ML_C + 64 * 68, ML_LF = ML_IG + 128, ML_BB = ML_LF + 128, ML_PM = ML_BB + 128,
              ML_WV = ML_PM + 128, ML_NP = ML_WV + 128, ML_CF = ML_NP + 64, ML_BE = ML_CF + 64, ML_ML = ML_BE + 64, ML_MISC = ML_ML + 64;
static_assert((ML_MISC + 8) * 4 <= 131072, "mLSTM LDS");

struct MlArgs { const bf16_t* proj; const bf16_t* vt; const float* gates; const float* cw; const float* cb; const float* ib; const float* fb; const float* ng;
                float* uloc; float* nkloc; float* scal; bf16_t* y; };

__device__ __forceinline__ float logsig(float x) { return fminf(x, 0.f) - log1pf(__expf(-fabsf(x))); }

__device__ __forceinline__ void ml_gates(LAS float* L, const MlArgs& A, size_t row0, int h, int tid) {
    if (tid < 128) { const float* gp = A.gates + (row0 + tid) * 8; L[ML_IG + tid] = gp[h] + A.ib[h]; L[ML_LF + tid] = logsig(gp[4 + h] + A.fb[h]); }
    __syncthreads();
    { float s = 0.f;
#pragma unroll 4
        for (int j = 0; j < 128; ++j) { const float v = L[ML_LF + j]; s += (j <= tid) ? v : 0.f; }
        if (tid < 128) L[ML_BB + tid] = s; }
    __syncthreads();
}
__device__ __forceinline__ void ml_stage_conv(LAS float* dst, const MlArgs& A, size_t rowbase, int t0, int h, int chbase, float scale, int tid) {
    const int d = tid & 63, ch = chbase + h * 64 + d; const float w0 = A.cw[ch], w1 = A.cw[512 + ch], w2 = A.cw[1024 + ch], w3 = A.cw[1536 + ch], cbv = A.cb[ch];
#pragma unroll 2
    for (int it = 0; it < 16; ++it) { const int l = it * 8 + (tid >> 6), t = t0 + l; const bf16_t* p = A.proj + (rowbase + t) * PLD + 1536 + ch;
        float acc = cbv + w3 * bf2f(p[0]);
        if (t >= 1) acc += w2 * bf2f(*(p - PLD)); if (t >= 2) acc += w1 * bf2f(*(p - 2 * PLD)); if (t >= 3) acc += w0 * bf2f(*(p - 3 * PLD));
        const float sv = acc / (1.f + __expf(-acc)); dst[l * 68 + d] = sv * scale; }
}
__device__ __forceinline__ void ml_stage_v(LAS float* dst, const MlArgs& A, int b, int h, int t0, int tid) {
    const int l = tid & 127;
#pragma unroll 4
    for (int it = 0; it < 16; ++it) { const int dv = (tid >> 7) + 4 * it; dst[l * 68 + dv] = bf2f(A.vt[(size_t)(b * 256 + h * 64 + dv) * SEQ + t0 + l]); }
}

__device__ __forceinline__ void ml_pass_a(LAS float* L, const MlArgs& A, int unit, int tid) {
#ifdef NO_MLA
    return;
#endif

    const int b = unit >> 8, h = (unit >> 6) & 3, c = unit & 63, t0 = c * 128; const size_t rowbase = (size_t)b * SEQ;
    ml_gates(L, A, rowbase + t0, h, tid);
    const float b_end = L[ML_BB + 127];
    if (tid < 128) L[ML_PM + tid] = b_end - L[ML_BB + tid] + L[ML_IG + tid];
    ml_stage_conv(L + ML_K, A, rowbase, t0, h, 256, 0.125f, tid);
    ml_stage_v(L + ML_V, A, b, h, t0, tid);
    __syncthreads();
    float mloc = -INFINITY;
#pragma unroll 4
    for (int j = 0; j < 128; ++j) mloc = fmaxf(mloc, L[ML_PM + j]);
    if (tid < 128) L[ML_WV + tid] = __expf(L[ML_PM + tid] - mloc);
    __syncthreads();
    const int dk = tid >> 3, dv0 = (tid & 7) * 8;
    float acc[8] = {0.f, 0.f, 0.f, 0.f, 0.f, 0.f, 0.f, 0.f};
#pragma unroll 2
    for (int l = 0; l < 128; ++l) { const float kw = L[ML_K + l * 68 + dk] * L[ML_WV + l];
        const f32x4 v0 = *(const LAS f32x4*)(L + ML_V + l * 68 + dv0), v1 = *(const LAS f32x4*)(L + ML_V + l * 68 + dv0 + 4);
        acc[0] += kw * v0[0]; acc[1] += kw * v0[1]; acc[2] += kw * v0[2]; acc[3] += kw * v0[3]; acc[4] += kw * v1[0]; acc[5] += kw * v1[1]; acc[6] += kw * v1[2]; acc[7] += kw * v1[3]; }
    float* up = A.uloc + ((size_t)unit * 64 + dk) * 64 + dv0;
    *(f32x4*)up = (f32x4){acc[0], acc[1], acc[2], acc[3]}; *(f32x4*)(up + 4) = (f32x4){acc[4], acc[5], acc[6], acc[7]};
    if (tid < 64) { float s = 0.f;
#pragma unroll 4
        for (int l = 0; l < 128; ++l) s += L[ML_K + l * 68 + tid] * L[ML_WV + l]; A.nkloc[(size_t)unit * 64 + tid] = s; }
    if (tid == 0) { A.scal[unit * 2] = b_end; A.scal[unit * 2 + 1] = mloc; }
    __syncthreads();
}

__device__ __forceinline__ void ml_pass_c(LAS float* L, const MlArgs& A, int unit, int tid) {
#ifdef NO_MLC
    return;
#endif

    const int b = unit >> 8, h = (unit >> 6) & 3, c = unit & 63, t0 = c * 128, ubase = unit - c; const size_t rowbase = (size_t)b * SEQ;
    ml_gates(L, A, rowbase + t0, h, tid);
    { float mx = -INFINITY;
#pragma unroll 4
        for (int j = 0; j < 128; ++j) { const float v = L[ML_IG + j] - L[ML_BB + j]; mx = (j <= tid) ? fmaxf(mx, v) : mx; }
        if (tid < 128) L[ML_PM + tid] = mx; }
    if (tid >= 128 && tid < 128 + c) { const int j = tid - 128; L[ML_BE + j] = A.scal[(ubase + j) * 2]; L[ML_ML + j] = A.scal[(ubase + j) * 2 + 1]; }
    __syncthreads();
    if (tid == 0) { float m = 0.f;
#pragma unroll 1
        for (int j = 0; j < c; ++j) m = fmaxf(L[ML_BE + j] + m, L[ML_ML + j]);
        float Bs = 0.f;
#pragma unroll 1
        for (int j = c - 1; j >= 0; --j) { L[ML_CF + j] = __expf(Bs + L[ML_ML + j] - m); Bs += L[ML_BE + j]; }
        L[ML_MISC] = m; }
    ml_stage_conv(L + ML_Q, A, rowbase, t0, h, 0, 1.f, tid);
    ml_stage_conv(L + ML_K, A, rowbase, t0, h, 256, 0.125f, tid);
    ml_stage_v(L + ML_V, A, b, h, t0, tid);
    __syncthreads();
    {
        const int dk = tid >> 3, dv0 = (tid & 7) * 8;
        f32x4 a0 = (f32x4){0.f, 0.f, 0.f, 0.f}, a1 = a0;
#pragma unroll 1
        for (int j = 0; j < c; ++j) { const float cf = L[ML_CF + j]; if (cf != 0.f) { const float* up = A.uloc + ((size_t)(ubase + j) * 64 + dk) * 64 + dv0; a0 += *(const f32x4*)up * cf; a1 += *(const f32x4*)(up + 4) * cf; } }
        *(LAS f32x4*)(L + ML_C + dk * 68 + dv0) = a0; *(LAS f32x4*)(L + ML_C + dk * 68 + dv0 + 4) = a1;
        if (tid < 64) { float s = 0.f;
#pragma unroll 1
            for (int j = 0; j < c; ++j) s += L[ML_CF + j] * A.nkloc[(size_t)(ubase + j) * 64 + tid]; L[ML_NP + tid] = s; }
    }
    __syncthreads();
    const float m_prev = L[ML_MISC];
    const int l = tid >> 2, part = tid & 3;
    const float bl = L[ML_BB + l];
    const float mt = fmaxf(bl + m_prev, bl + L[ML_PM + l]);
    const float inter = __expf(bl + m_prev - mt);
    float num[64];
#pragma unroll
    for (int i = 0; i < 64; ++i) num[i] = 0.f;
    float den = 0.f;
#pragma unroll 1
    for (int kk = 0; kk < 16; ++kk) {
        const int dk = part * 16 + kk;
        const float qd = L[ML_Q + l * 68 + dk] * inter;
        den += qd * L[ML_NP + dk];
#pragma unroll
        for (int d4 = 0; d4 < 16; ++d4) { const f32x4 cv = *(const LAS f32x4*)(L + ML_C + dk * 68 + 4 * d4); num[4 * d4] += qd * cv[0]; num[4 * d4 + 1] += qd * cv[1]; num[4 * d4 + 2] += qd * cv[2]; num[4 * d4 + 3] += qd * cv[3]; }
        __builtin_amdgcn_sched_barrier(0);
    }
    float q[64];
#pragma unroll
    for (int d4 = 0; d4 < 16; ++d4) { const f32x4 v = *(const LAS f32x4*)(L + ML_Q + l * 68 + 4 * d4); q[4 * d4] = v[0]; q[4 * d4 + 1] = v[1]; q[4 * d4 + 2] = v[2]; q[4 * d4 + 3] = v[3]; }
    {
        const int lmax = ((tid >> 6) << 4) + 15;
        const int s_lo = part * 32; int s_hi = s_lo + 31; if (s_hi > lmax) s_hi = lmax;
#pragma unroll 1
        for (int s = s_lo; s <= s_hi; ++s) {
            float dot = 0.f;
#pragma unroll
            for (int d8 = 0; d8 < 4; ++d8) {
#pragma unroll
                for (int dd = 0; dd < 4; ++dd) { const int d4 = d8 * 4 + dd; const f32x4 kv = *(const LAS f32x4*)(L + ML_K + s * 68 + 4 * d4); dot += q[4 * d4] * kv[0] + q[4 * d4 + 1] * kv[1] + q[4 * d4 + 2] * kv[2] + q[4 * d4 + 3] * kv[3]; }
                __builtin_amdgcn_sched_barrier(0);
            }
            const float sc = (s <= l) ? dot * __expf(bl - L[ML_BB + s] + L[ML_IG + s] - mt) : 0.f;
            den += sc;
#pragma unroll
            for (int d8 = 0; d8 < 4; ++d8) {
#pragma unroll
                for (int dd = 0; dd < 4; ++dd) { const int d4 = d8 * 4 + dd; const f32x4 vv = *(const LAS f32x4*)(L + ML_V + s * 68 + 4 * d4); num[4 * d4] += sc * vv[0]; num[4 * d4 + 1] += sc * vv[1]; num[4 * d4 + 2] += sc * vv[2]; num[4 * d4 + 3] += sc * vv[3]; }
                __builtin_amdgcn_sched_barrier(0);
            }
        }
    }
    den += __shfl_xor(den, 1); den += __shfl_xor(den, 2);
    const float dn = 1.f / fmaxf(fabsf(den), __expf(-mt));
    float mu = 0.f;
#pragma unroll
    for (int i = 0; i < 64; ++i) { float v = num[i]; v += __shfl_xor(v, 1); v += __shfl_xor(v, 2); v *= dn; num[i] = v; mu += v; }
    mu *= (1.f / 64.f);
    float var = 0.f;
#pragma unroll
    for (int i = 0; i < 64; ++i) { const float d = num[i] - mu; var += d * d; }
    const float rs = 1.f / sqrtf(var * (1.f / 64.f) + LN_EPS);
    const size_t row = rowbase + t0 + l;
    const bf16_t* op = A.proj + row * PLD + 2304 + h * 64; bf16_t* yp = A.y + row * DM + 768 + h * 64; const float* ngp = A.ng + h * 64;
#pragma unroll
    for (int i = 0; i < 64; ++i) if ((i >> 4) == part) { const float og = bf2f(op[i]); const float sg = 1.f / (1.f + __expf(-og)); yp[i] = (bf16_t)f2bf(sg * (num[i] - mu) * rs * ngp[i]); }
    __syncthreads();
}

struct Params { const float* in[20]; float* out; unsigned char* ws; };

struct GrpOrder {
    int kind, nM, nN, ng, G, c;
    __device__ bool next(int i, pg8::Unit& u) const {
        const long L = (long)i * G + c; if (L >= (long)ng * nM * nN) return false;
        const int g = (int)(L / (nM * nN)), rem = (int)(L % (nM * nN)); u.g = g; u.pm = rem % nM; u.pn = rem / nM; return true;
    }
    __device__ __forceinline__ long a_off(const pg8::Unit& u) const {
        if (kind == 0) return (long)u.pm * 256 * 1024;
        const int l = u.g >> 4, b = (u.g >> 2) & 3, h = u.g & 3;
        if (kind == 1) return (long)l * 1024 * 2048 + (long)b * 256 * 2048 + h * 256;
        return (long)l * 1024 * 1024 + (long)u.pm * 256 * 1024 + h * 256;
    }
    __device__ __forceinline__ long b_off(const pg8::Unit& u) const {
        if (kind == 0) return (long)u.g * 2048 * 1024 + (long)u.pn * 256 * 1024;
        const int l = u.g >> 4, b = (u.g >> 2) & 3, h = u.g & 3;
        if (kind == 1) return (long)l * 1024 * 1024 + (long)u.pn * 256 * 1024 + h * 256;
        return (long)l * 1024 * 2048 + (long)b * 256 * 2048 + 1024 + h * 256;
    }
};

__device__ __forceinline__ void gsync(unsigned* ctr, unsigned& epoch, unsigned G, int wave) {
    asm volatile("s_waitcnt vmcnt(0) lgkmcnt(0)" ::: "memory");
    __syncthreads();
    ++epoch;
    if (lane_fresh() == 0 && sopq(wave) == 0) {
        __builtin_amdgcn_fence(__ATOMIC_RELEASE, "agent");
        __hip_atomic_fetch_add(ctr, 1u, __ATOMIC_RELAXED, __HIP_MEMORY_SCOPE_AGENT);
        const unsigned want = epoch * G;
        while (__hip_atomic_load(ctr, __ATOMIC_RELAXED, __HIP_MEMORY_SCOPE_AGENT) < want) __builtin_amdgcn_s_sleep(2);
        __builtin_amdgcn_fence(__ATOMIC_ACQUIRE, "agent");
    }
    __syncthreads();
}
__device__ __forceinline__ size_t oz() { size_t z = 0; asm volatile("" : "+s"(z)); return z; }
typedef const __attribute__((address_space(4))) unsigned char* kptr_t;
__device__ __forceinline__ unsigned char* karg(int k, size_t z) { kptr_t ka = (kptr_t)__builtin_amdgcn_kernarg_segment_ptr(); return *(unsigned char* const __attribute__((address_space(4)))*)(ka + 8 * k + z); }
#define PIN(k) ((const float*)karg((k), _z))
#define POUT ((float*)karg(20, _z))
#define WSP(type, off) ((type*)(karg(21, _z) + (off)))

__global__ void __launch_bounds__(NTHR, 2) mega(Params p) {
    extern __shared__ __attribute__((aligned(16))) unsigned char lds_raw[];
    LAS unsigned char* lds = (LAS unsigned char*)lds_raw;
    cg::grid_group grid = cg::this_grid();
    const int wave = __builtin_amdgcn_readfirstlane(threadIdx.x >> 6);
    const int G = gridDim.x, bid = blockIdx.x;
    const int gw = bid * NWAVES + wave, ngw = G * NWAVES;
    unsigned epoch = 0;
#define GSYNC() do { const size_t _z = oz(); gsync(WSP(unsigned, WS_CTR), epoch, (unsigned)G, wave); } while (0)

    {
        const size_t _z = oz(); const int lane = lane_fresh(), tid = wave * 64 + lane; (void)tid;
        bf16_t* WFI = WSP(bf16_t, WS_WFI); bf16_t* WFO = WSP(bf16_t, WS_WFO); bf16_t* WMI = WSP(bf16_t, WS_WMI); bf16_t* WMO = WSP(bf16_t, WS_WMO);
        bf16_t* WKVT = WSP(bf16_t, WS_WKVT); bf16_t* WOT = WSP(bf16_t, WS_WOT);
        LAS float* scr = (LAS float*)(lds + wave * 16384);
        constexpr int I_FI = 16 * 176, I_FO = 44 * 32, I_MI = 16 * 88, I_MO = 16 * 32, I_KV = 16 * 64, I_WO = 16 * 32;
        constexpr int PER_L = 2 * I_FI + 2 * I_FO + I_MI + I_MO + I_KV + I_WO;
#pragma unroll 1
        for (int it = gw; it < DEPTH * PER_L; it += ngw) {
            const int l = it / PER_L; int r = it % PER_L;
            if (r < I_FI) { tr_item(PIN(2) + (size_t)l * DM * 2 * DFF, DM, 2 * DFF, 2 * DFF, WFI + (size_t)(l * 2 + 0) * 2 * DFF * DM, 1, scr, r, lane); continue; } r -= I_FI;
            if (r < I_FI) { tr_item(PIN(16) + (size_t)l * DM * 2 * DFF, DM, 2 * DFF, 2 * DFF, WFI + (size_t)(l * 2 + 1) * 2 * DFF * DM, 1, scr, r, lane); continue; } r -= I_FI;
            if (r < I_FO) { tr_item(PIN(3) + (size_t)l * DFF * DM, DFF, DM, DM, WFO + (size_t)(l * 2 + 0) * DM * DFF, 0, scr, r, lane); continue; } r -= I_FO;
            if (r < I_FO) { tr_item(PIN(17) + (size_t)l * DFF * DM, DFF, DM, DM, WFO + (size_t)(l * 2 + 1) * DM * DFF, 0, scr, r, lane); continue; } r -= I_FO;
            if (r < I_MI) { tr_item(PIN(4) + (size_t)l * DM * NIN, DM, NIN, NINP, WMI + (size_t)l * NINP * DM, 2, scr, r, lane); continue; } r -= I_MI;
            if (r < I_MO) { tr_item(PIN(12) + (size_t)l * DM * DM, DM, DM, DM, WMO + (size_t)l * DM * DM, 0, scr, r, lane); continue; } r -= I_MO;
            if (r < I_KV) { tr_item(PIN(14) + (size_t)l * DM * 2 * DM, DM, 2 * DM, 2 * DM, WKVT + (size_t)l * 2 * DM * DM, 0, scr, r, lane); continue; } r -= I_KV;
            tr_item(PIN(15) + (size_t)l * DM * DM, DM, DM, DM, WOT + (size_t)l * DM * DM, 0, scr, r, lane);
        }
        const size_t gt = (size_t)bid * NTHR + tid, ngt = (size_t)G * NTHR;
        cvt_range(PIN(0), WSP(bf16_t, WS_XB), (size_t)T * DM / 8, gt, ngt);
        cvt_range(PIN(1), WSP(bf16_t, WS_MEMB), (size_t)BATCH * MEMT * DM / 8, gt, ngt);
        cvt_range(PIN(13), WSP(bf16_t, WS_WQB), (size_t)DEPTH * DM * DM / 8, gt, ngt);
        if (bid == 0) { float* biasT = WSP(float, WS_BIAST);
            for (int i = tid; i < 8 * 128; i += NTHR) { const int hq = i >> 7, d = i & 127;
                int bk = d; if (d >= 16) { bk = 16 + (int)(log2f((float)d * (1.f / 16.f)) * (16.f / 3.f)); if (bk > 31) bk = 31; }
                biasT[i] = PIN(11)[bk * 8 + hq]; } }
    }
    grid.sync();
    {
        const size_t _z = oz(); const int lane = lane_fresh(), tid = wave * 64 + lane; (void)tid;
        pg8::Gemm g{WSP(bf16_t, WS_MEMB), WSP(bf16_t, WS_WKVT), 1024, 1024, 1024}; GrpOrder S{0, 4, 8, DEPTH, G, bid}; pg8::EpiBf16G E{WSP(bf16_t, WS_KV), 2048, 1.f, 0};
        pg8::gemm_phase(lds, g, S, E, wave);
    }
    GSYNC();
    {
        const size_t _z = oz(); const int lane = lane_fresh(), tid = wave * 64 + lane; (void)tid;
        { pg8::Gemm g{WSP(bf16_t, WS_KV), WSP(bf16_t, WS_WQB), 2048, 1024, 256}; GrpOrder S{1, 1, 4, DEPTH * 16, G, bid}; pg8::EpiBf16G E{WSP(bf16_t, WS_WQK), 1024, LOG2E / 16.f, 1}; pg8::gemm_phase(lds, g, S, E, wave); }
        { pg8::Gemm g{WSP(bf16_t, WS_WOT), WSP(bf16_t, WS_KV), 1024, 2048, 256}; GrpOrder S{2, 4, 1, DEPTH * 16, G, (bid + 128) % G}; pg8::EpiBf16G E{WSP(bf16_t, WS_VWO), 1024, 1.f, 2}; pg8::gemm_phase(lds, g, S, E, wave); }
    }
    GSYNC();

#pragma unroll 1
    for (int l = 0; l < DEPTH; ++l) {
#pragma unroll 1
        for (int f = 0; f < 2; ++f) {
            if (f == 1) {
                { const size_t _z = oz(); const int lane = lane_fresh(), tid = wave * 64 + lane; (void)tid;
                  pg8::Gemm g{WSP(bf16_t, WS_XB), WSP(bf16_t, WS_WMI) + (size_t)l * NINP * DM, DM, DM, DM}; pg8::BigOrder S; S.init(T, NINP, G, bid, DM, DM, 0);
                  pg8::EpiMixIn E{WSP(bf16_t, WS_R1), WSP(bf16_t, WS_VTSB), WSP(bf16_t, WS_VTSW), WSP(bf16_t, WS_VTML), WSP(float, WS_GATES)}; pg8::gemm_phase(lds, g, S, E, wave); }
                GSYNC();
                { const size_t _z = oz(); const int lane = lane_fresh(), tid = wave * 64 + lane; (void)tid;
                  MlArgs MA{WSP(bf16_t, WS_R1), WSP(bf16_t, WS_VTML), WSP(float, WS_GATES), PIN(5) + (size_t)l * 4 * 512, PIN(6) + (size_t)l * 512, PIN(7) + l * 4, PIN(8) + l * 4, PIN(9) + l * 256,
                            WSP(float, WS_ULOC), WSP(float, WS_NKLOC), WSP(float, WS_SCAL), WSP(bf16_t, WS_XB)};
                  LAS float* L = (LAS float*)lds;
#pragma unroll 1
                  for (int u = bid; u < 1024; u += G) ml_pass_a(L, MA, u, tid);
                }
                { const size_t _z = oz(); const int lane = lane_fresh(), tid = wave * 64 + lane; (void)tid;
                  const bf16_t* PROJ = WSP(bf16_t, WS_R1); bf16_t* Y = WSP(bf16_t, WS_XB);
#pragma unroll 1
                  for (int u = bid; u < 1024; u += G) { const int b = u >> 8, hq = (u >> 5) & 7, blk = u & 31; swa_wave(PROJ, WSP(bf16_t, WS_VTSW), WSP(float, WS_BIAST), PIN(10) + l * 8, Y, b, hq, blk * 8 + wave, lane); }
#pragma unroll 1
                  for (int u = bid; u < 512; u += G) { const int b = u >> 7, h = (u >> 5) & 3, blk = u & 31; sb_wave(PROJ, WSP(bf16_t, WS_VTSB), Y, b, h, blk * 8 + wave, lane); }
                }
                GSYNC();
                { const size_t _z = oz(); const int lane = lane_fresh(), tid = wave * 64 + lane; (void)tid;
                  MlArgs MA{WSP(bf16_t, WS_R1), WSP(bf16_t, WS_VTML), WSP(float, WS_GATES), PIN(5) + (size_t)l * 4 * 512, PIN(6) + (size_t)l * 512, PIN(7) + l * 4, PIN(8) + l * 4, PIN(9) + l * 256,
                            WSP(float, WS_ULOC), WSP(float, WS_NKLOC), WSP(float, WS_SCAL), WSP(bf16_t, WS_XB)};
                  LAS float* L = (LAS float*)lds;
#pragma unroll 1
                  for (int u = bid; u < 1024; u += G) { const int uu = (u & ~63) | ((u & 1) ? (63 - ((u & 63) >> 1)) : ((u & 63) >> 1)); ml_pass_c(L, MA, uu, tid); }
                }
                GSYNC();
                { const size_t _z = oz(); const int lane = lane_fresh(), tid = wave * 64 + lane; (void)tid;
                  pg8::Gemm g{WSP(bf16_t, WS_XB), WSP(bf16_t, WS_WMO) + (size_t)l * DM * DM, DM, DM, DM}; pg8::BigOrder S; S.init(T, DM, G, bid, DM, DM, 0);
                  pg8::EpiResid E{POUT, WSP(float, WS_PRE), 1.f}; pg8::gemm_phase(lds, g, S, E, wave); }
                GSYNC();
                { const size_t _z = oz(); const int lane = lane_fresh(), tid = wave * 64 + lane; (void)tid; ln_rows(WSP(float, WS_PRE), PIN(18) + (size_t)(l * 4 + 1) * DM, PIN(19) + (size_t)(l * 4 + 1) * DM, POUT, WSP(bf16_t, WS_XB), gw, ngw, lane); }
                GSYNC();
                { const size_t _z = oz(); const int lane = lane_fresh(), tid = wave * 64 + lane; (void)tid;
                  pg8::Gemm g{WSP(bf16_t, WS_XB), WSP(bf16_t, WS_WQK) + (size_t)l * 4 * DM * DM, DM, DM, DM}; pg8::BigOrder S; S.init(T, DM, G, bid, DM, DM, (long)DM * DM);
                  pg8::EpiSoftmax E{WSP(bf16_t, WS_R1)}; pg8::gemm_phase(lds, g, S, E, wave); }
                GSYNC();
                { const size_t _z = oz(); const int lane = lane_fresh(), tid = wave * 64 + lane; (void)tid;
                  pg8::Gemm g{WSP(bf16_t, WS_R1), WSP(bf16_t, WS_VWO) + (size_t)l * 4 * DM * DM, DM, DM, DM}; pg8::BigOrder S; S.init(T, DM, G, bid, DM, DM, (long)DM * DM);
                  pg8::EpiResid E{POUT, WSP(float, WS_PRE), 1.f}; pg8::gemm_phase(lds, g, S, E, wave); }
                GSYNC();
                { const size_t _z = oz(); const int lane = lane_fresh(), tid = wave * 64 + lane; (void)tid; ln_rows(WSP(float, WS_PRE), PIN(18) + (size_t)(l * 4 + 2) * DM, PIN(19) + (size_t)(l * 4 + 2) * DM, POUT, WSP(bf16_t, WS_XB), gw, ngw, lane); }
                GSYNC();
            }
            { const size_t _z = oz(); const int lane = lane_fresh(), tid = wave * 64 + lane; (void)tid;
              pg8::Gemm g{WSP(bf16_t, WS_XB), WSP(bf16_t, WS_WFI) + (size_t)(l * 2 + f) * 2 * DFF * DM, DM, DM, DM}; pg8::BigOrder S; S.init(T, 2 * DFF, G, bid, DM, DM, 0);
              pg8::EpiSwiGLU E{WSP(bf16_t, WS_R1)}; pg8::gemm_phase(lds, g, S, E, wave); }
            GSYNC();
            { const size_t _z = oz(); const int lane = lane_fresh(), tid = wave * 64 + lane; (void)tid;
              const float* xres = (l == 0 && f == 0) ? PIN(0) : POUT;
              pg8::Gemm g{WSP(bf16_t, WS_R1), WSP(bf16_t, WS_WFO) + (size_t)(l * 2 + f) * DM * DFF, DFF, DFF, DFF}; pg8::BigOrder S; S.init(T, DM, G, bid, DFF, DFF, 0);
              pg8::EpiResid E{xres, WSP(float, WS_PRE), 0.5f}; pg8::gemm_phase(lds, g, S, E, wave); }
            GSYNC();
            { const size_t _z = oz(); const int lane = lane_fresh(), tid = wave * 64 + lane; (void)tid; const int li = l * 4 + (f ? 3 : 0);
              ln_rows(WSP(float, WS_PRE), PIN(18) + (size_t)li * DM, PIN(19) + (size_t)li * DM, POUT, WSP(bf16_t, WS_XB), gw, ngw, lane); }
            if (!(l == DEPTH - 1 && f == 1)) GSYNC();
        }
    }
}

extern "C" void kernel_launch(void* const* d_in, const int* in_sizes, int n_in, void* d_out, int out_size, void* d_ws, size_t ws_size, hipStream_t stream) {
    static int grid_blocks = 0;
    if (grid_blocks == 0) {
        if (n_in != 20 || out_size != T * DM || ws_size < WS_END) { fprintf(stderr, "kernel_launch: unexpected shapes (n_in %d out %d ws %zu)\n", n_in, out_size, ws_size); grid_blocks = -1; return; }
        int dev = 0, cus = 0, per_cu = 0;
        hipGetDevice(&dev);
        hipDeviceGetAttribute(&cus, hipDeviceAttributeMultiprocessorCount, dev);
        hipFuncSetAttribute((const void*)mega, hipFuncAttributeMaxDynamicSharedMemorySize, LDS_BYTES);
        hipOccupancyMaxActiveBlocksPerMultiprocessor(&per_cu, (const void*)mega, NTHR, LDS_BYTES);
        if (per_cu < 1) per_cu = 1;
        grid_blocks = cus * per_cu;
        (void)hipGetLastError();
    }
    if (grid_blocks < 0) return;
    Params p{};
    for (int i = 0; i < 20; ++i) p.in[i] = (const float*)d_in[i];
    p.out = (float*)d_out; p.ws = (unsigned char*)d_ws;
    hipMemsetAsync((char*)d_ws + WS_CTR, 0, 256, stream);
    void* args[] = {&p};
    hipError_t e = hipLaunchCooperativeKernel((const void*)mega, dim3(grid_blocks), dim3(NTHR), args, LDS_BYTES, stream);
    if (e != hipSuccess) fprintf(stderr, "cooperative launch failed: %s (grid %d)\n", hipGetErrorString(e), grid_blocks);
}
```
